# Optimizing an MI355X kernel written in HIP

```python
import math
import jax, jax.numpy as jnp
from jax import lax
import numpy as np

D_MODEL = 1024
BATCH = 4
SEQ = 4096
DEPTH = 4

N_MIXERS = 2
N_A_LAYERS = (DEPTH + 1) // 2
N_B_LAYERS = DEPTH // 2
GMLP_WIDTH = D_MODEL
GMLP_CHUNK = 128
GMLP_GROUPS = 8
GMLP_GROUP_DIM = GMLP_WIDTH // GMLP_GROUPS
N_HEADS = 16
HEAD_DIM = D_MODEL // N_HEADS
MOBA_BLOCK = 256
MOBA_TOPK = 3
Q_CHUNK = 128
REL_BUCKETS = 32
REL_MAX_DIST = 128
FFN_DIM = 2816
CONV_WIDTH = 3
LN_EPS = 1e-5
DN_ALPHA = (2 * DEPTH) ** 0.25
DN_BETA = (8 * DEPTH) ** -0.25

kernel_name = "hybrid_gmlp_moba_convffn_deepnorm"


def layer_norm(x, g, b):
    xf = x.astype(jnp.float32)
    mu = jnp.mean(xf, axis=-1, keepdims=True)
    var = jnp.mean(jnp.square(xf - mu), axis=-1, keepdims=True)
    y = (xf - mu) * lax.rsqrt(var + LN_EPS)
    return (y * g.astype(jnp.float32) + b.astype(jnp.float32)).astype(x.dtype)


def rel_bucket(dist):
    n = jnp.maximum(dist, 0)
    max_exact = REL_BUCKETS // 2
    nf = jnp.maximum(n, 1).astype(jnp.float32)
    large = max_exact + (jnp.log(nf / max_exact) / math.log(REL_MAX_DIST / max_exact)
                         * (REL_BUCKETS - max_exact)).astype(jnp.int32)
    large = jnp.minimum(large, REL_BUCKETS - 1)
    return jnp.where(n < max_exact, n, large)


def chunked_gmlp(x, w_in, ln_g, ln_b, w_s, b_s, w_out):
    B, S, _ = x.shape
    z = jax.nn.gelu(x @ w_in)
    u, v = jnp.split(z, 2, axis=-1)
    v = layer_norm(v, ln_g, ln_b)
    nc = S // GMLP_CHUNK
    v = v.reshape(B, nc, GMLP_CHUNK, GMLP_GROUPS, GMLP_GROUP_DIM)
    causal = jnp.tril(jnp.ones((GMLP_CHUNK, GMLP_CHUNK), dtype=bool))
    w = jnp.where(causal[None], w_s, jnp.zeros_like(w_s))
    sv = jnp.einsum('gts,bnsgc->bntgc', w, v) + b_s.T[None, None, :, :, None]
    return (u * sv.reshape(B, S, GMLP_WIDTH)) @ w_out


def moba_attention(x, w_qkv, w_o, rel_bias):
    B, S, _ = x.shape
    H, Dh, L = N_HEADS, HEAD_DIM, MOBA_BLOCK
    nb = -(-S // L)
    sp = nb * L
    nq = S // Q_CHUNK
    topk = min(MOBA_TOPK, nb)
    qkv = (x @ w_qkv).reshape(B, S, 3, H, Dh)
    q = jnp.transpose(qkv[:, :, 0], (0, 2, 1, 3)) * (Dh ** -0.5)
    pad = ((0, 0), (0, 0), (0, sp - S), (0, 0))
    k = jnp.pad(jnp.transpose(qkv[:, :, 1], (0, 2, 1, 3)), pad)
    v = jnp.pad(jnp.transpose(qkv[:, :, 2], (0, 2, 1, 3)), pad)
    kb = k.reshape(B, H, nb, L, Dh)
    vb = v.reshape(B, H, nb, L, Dh)
    kbar = jnp.mean(kb.astype(jnp.float32), axis=3).astype(k.dtype)
    bias_hb = rel_bias.T
    qc = jnp.moveaxis(q.reshape(B, H, nq, Q_CHUNK, Dh), 2, 0)
    bi = jnp.arange(B)[:, None, None, None]
    hi = jnp.arange(H)[None, :, None, None]
    hi5 = hi[..., None]
    blk = jnp.arange(nb)
    off = jnp.arange(L)

    def chunk_fn(args):
        c, q_c = args
        t = c * Q_CHUNK + jnp.arange(Q_CHUNK)
        cur = (c * Q_CHUNK) // L
        gate = jnp.einsum('bhqd,bhnd->bhqn', q_c, kbar).astype(jnp.float32)
        gate = jnp.where(blk < cur, gate, -jnp.inf)
        _, idx = lax.top_k(gate, topk)
        sel_ok = idx < cur
        k_sel = kb[bi, hi, idx]
        v_sel = vb[bi, hi, idx]
        k_own = lax.dynamic_index_in_dim(kb, cur, axis=2, keepdims=False)
        v_own = lax.dynamic_index_in_dim(vb, cur, axis=2, keepdims=False)
        s_sel = jnp.einsum('bhqd,bhqjld->bhqjl', q_c, k_sel).astype(jnp.float32)
        s_own = jnp.einsum('bhqd,bhld->bhql', q_c, k_own).astype(jnp.float32)
        d_sel = t[None, None, :, None, None] - (idx[..., None] * L + off)
        d_own = t[:, None] - (cur * L + off)[None, :]
        s_sel = s_sel + bias_hb[hi5, rel_bucket(d_sel)].astype(jnp.float32)
        s_own = s_own + bias_hb[:, rel_bucket(d_own)][None].astype(jnp.float32)
        s_sel = jnp.where(sel_ok[..., None], s_sel, -jnp.inf)
        s_own = jnp.where(d_own >= 0, s_own, -jnp.inf)
        logits = jnp.concatenate([s_sel.reshape(B, H, Q_CHUNK, topk * L), s_own], axis=-1)
        p = jax.nn.softmax(logits, axis=-1)
        p_sel = p[..., :topk * L].reshape(B, H, Q_CHUNK, topk, L).astype(v.dtype)
        p_own = p[..., topk * L:].astype(v.dtype)
        return (jnp.einsum('bhqjl,bhqjld->bhqd', p_sel, v_sel)
                + jnp.einsum('bhql,bhld->bhqd', p_own, v_own))

    o = lax.map(chunk_fn, (jnp.arange(nq, dtype=jnp.int32), qc))
    o = jnp.transpose(o, (1, 0, 3, 2, 4)).reshape(B, S, H * Dh)
    return o @ w_o


def conv_ffn(x, w_up, conv_w, conv_b, w_down):
    S = x.shape[1]
    h = x @ w_up
    hp = jnp.pad(h, ((0, 0), (CONV_WIDTH - 1, 0), (0, 0)))
    hc = conv_b
    for j in range(CONV_WIDTH):
        hc = hc + conv_w[j] * hp[:, j:j + S]
    g, val = jnp.split(hc, 2, axis=-1)
    return (jax.nn.gelu(g) * val) @ w_down


def setup_inputs(seed: int = 0) -> dict:
    key = jax.random.key(seed)
    ks = jax.random.split(key, 20)
    f32 = jnp.float32
    D = D_MODEL

    def nrm(k, shape, scale):
        return jax.random.normal(k, shape, f32) * scale

    return {
        "x": nrm(ks[0], (BATCH, SEQ, D), 1.0),
        "ln_mix_g": 1.0 + nrm(ks[1], (DEPTH, D), 0.01),
        "ln_mix_b": nrm(ks[2], (DEPTH, D), 0.01),
        "ln_ffn_g": 1.0 + nrm(ks[3], (DEPTH, D), 0.01),
        "ln_ffn_b": nrm(ks[4], (DEPTH, D), 0.01),
        "a_w_in": nrm(ks[5], (N_A_LAYERS, D, 2 * GMLP_WIDTH), D ** -0.5),
        "a_ln_g": 1.0 + nrm(ks[6], (N_A_LAYERS, GMLP_WIDTH), 0.01),
        "a_ln_b": nrm(ks[7], (N_A_LAYERS, GMLP_WIDTH), 0.01),
        "a_w_s": nrm(ks[8], (N_A_LAYERS, GMLP_GROUPS, GMLP_CHUNK, GMLP_CHUNK), GMLP_CHUNK ** -0.5),
        "a_b_s": 1.0 + nrm(ks[9], (N_A_LAYERS, GMLP_GROUPS, GMLP_CHUNK), 0.01),
        "a_w_out": nrm(ks[10], (N_A_LAYERS, GMLP_WIDTH, D), GMLP_WIDTH ** -0.5 * DN_BETA),
        "b_w_qkv": nrm(ks[11], (N_B_LAYERS, D, 3 * D), D ** -0.5),
        "b_w_o": nrm(ks[12], (N_B_LAYERS, D, D), D ** -0.5 * DN_BETA),
        "rel_bias": nrm(ks[13], (REL_BUCKETS, N_HEADS), 0.5),
        "f_w_up": nrm(ks[14], (DEPTH, D, 2 * FFN_DIM), D ** -0.5),
        "f_conv_w": nrm(ks[15], (DEPTH, CONV_WIDTH, 2 * FFN_DIM), CONV_WIDTH ** -0.5),
        "f_conv_b": nrm(ks[16], (DEPTH, 2 * FFN_DIM), 0.01),
        "f_w_down": nrm(ks[17], (DEPTH, FFN_DIM, D), FFN_DIM ** -0.5 * DN_BETA),
    }


def reference(x, ln_mix_g, ln_mix_b, ln_ffn_g, ln_ffn_b, a_w_in, a_ln_g, a_ln_b, a_w_s,
              a_b_s, a_w_out, b_w_qkv, b_w_o, rel_bias, f_w_up, f_conv_w, f_conv_b,
              f_w_down):
    for i in range(DEPTH):
        j = i // N_MIXERS
        if i % N_MIXERS == 0:
            y = chunked_gmlp(x, a_w_in[j], a_ln_g[j], a_ln_b[j], a_w_s[j], a_b_s[j], a_w_out[j])
        else:
            y = moba_attention(x, b_w_qkv[j], b_w_o[j], rel_bias)
        x = layer_norm(DN_ALPHA * x + y, ln_mix_g[i], ln_mix_b[i])
        y = conv_ffn(x, f_w_up[i], f_conv_w[i], f_conv_b[i], f_w_down[i])
        x = layer_norm(DN_ALPHA * x + y, ln_ffn_g[i], ln_ffn_b[i])
    return x
```

```cpp
#include <hip/hip_runtime.h>
namespace nv {
constexpr int NB = 4, NS = 4096, ND = 1024, NM = NB * NS, NH = 16, NDH = 64, NF = 2816, NF2 = 5632;
constexpr float ALPHA = 1.681792830507429f;
__constant__ unsigned char c_bucket[129] = {0, 1, 2, 3, 4, 5, 6, 7, 8, 9, 10, 11, 12, 13, 14, 15, 16, 16, 16, 17, 17, 18, 18, 18, 19, 19, 19, 20, 20, 20, 20, 21, 21, 21, 21, 22, 22, 22, 22, 22, 23, 23, 23, 23, 23, 23, 24, 24, 24, 24, 24, 24, 25, 25, 25, 25, 25, 25, 25, 26, 26, 26, 26, 26, 26, 26, 26, 27, 27, 27, 27, 27, 27, 27, 27, 27, 27, 28, 28, 28, 28, 28, 28, 28, 28, 28, 28, 29, 29, 29, 29, 29, 29, 29, 29, 29, 29, 29, 29, 30, 30, 30, 30, 30, 30, 30, 30, 30, 30, 30, 30, 30, 30, 31, 31, 31, 31, 31, 31, 31, 31, 31, 31, 31, 31, 31, 31, 31, 31};

__device__ __forceinline__ float gelu_tanh(float x) {
    const float k0 = 0.7978845608028654f, k1 = 0.044715f;
    float u = k0 * (x + k1 * x * x * x);
    return 0.5f * x * (1.0f + tanhf(u));
}

template <int ACT>
__global__ void __launch_bounds__(256) gemm_f32(const float* __restrict__ A, int lda, const float* __restrict__ B, int ldb, float* __restrict__ C, int ldc, int K) {
    __shared__ float As[8][128 + 4];
    __shared__ float Bs[8][128 + 4];
    const int tid = threadIdx.x, tx = tid & 15, ty = tid >> 4;
    const int m0 = blockIdx.y * 128, n0 = blockIdx.x * 128;
    float acc[8][8];
#pragma unroll
    for (int i = 0; i < 8; ++i)
#pragma unroll
        for (int j = 0; j < 8; ++j) acc[i][j] = 0.f;
    const int ar = tid >> 1, ac = (tid & 1) * 4;
    const int br = tid >> 5, bc = (tid & 31) * 4;
    for (int k0 = 0; k0 < K; k0 += 8) {
        const float4 av = *(const float4*)(A + (size_t)(m0 + ar) * lda + k0 + ac);
        const float4 bv = *(const float4*)(B + (size_t)(k0 + br) * ldb + n0 + bc);
        __syncthreads();
        As[ac + 0][ar] = av.x; As[ac + 1][ar] = av.y; As[ac + 2][ar] = av.z; As[ac + 3][ar] = av.w;
        *(float4*)&Bs[br][bc] = bv;
        __syncthreads();
#pragma unroll
        for (int k = 0; k < 8; ++k) {
            float a[8], b[8];
            *(float4*)&a[0] = *(const float4*)&As[k][ty * 4]; *(float4*)&a[4] = *(const float4*)&As[k][64 + ty * 4];
            *(float4*)&b[0] = *(const float4*)&Bs[k][tx * 4]; *(float4*)&b[4] = *(const float4*)&Bs[k][64 + tx * 4];
#pragma unroll
            for (int i = 0; i < 8; ++i)
#pragma unroll
                for (int j = 0; j < 8; ++j) acc[i][j] = fmaf(a[i], b[j], acc[i][j]);
        }
    }
#pragma unroll
    for (int i = 0; i < 8; ++i) {
        const int r = m0 + (i < 4 ? ty * 4 + i : 64 + ty * 4 + (i - 4));
#pragma unroll
        for (int jh = 0; jh < 2; ++jh) {
            float4 o; o.x = acc[i][jh * 4 + 0]; o.y = acc[i][jh * 4 + 1]; o.z = acc[i][jh * 4 + 2]; o.w = acc[i][jh * 4 + 3];
            if (ACT == 1) { o.x = gelu_tanh(o.x); o.y = gelu_tanh(o.y); o.z = gelu_tanh(o.z); o.w = gelu_tanh(o.w); }
            *(float4*)(C + (size_t)r * ldc + n0 + jh * 64 + tx * 4) = o;
        }
    }
}

__global__ void __launch_bounds__(256) ln_rows(const float* in, int ld_in, const float* add, int ld_add, float alpha, const float* __restrict__ g, const float* __restrict__ b, float* out, int ld_out) {
    __shared__ float red[8];
    const int row = blockIdx.x, tid = threadIdx.x;
    float4 v = *(const float4*)(in + (size_t)row * ld_in + tid * 4);
    if (add) { const float4 a = *(const float4*)(add + (size_t)row * ld_add + tid * 4); v.x = alpha * v.x + a.x; v.y = alpha * v.y + a.y; v.z = alpha * v.z + a.z; v.w = alpha * v.w + a.w; }
    float s = (v.x + v.y) + (v.z + v.w);
    for (int o = 32; o > 0; o >>= 1) s += __shfl_xor(s, o);
    if ((tid & 63) == 0) red[tid >> 6] = s;
    __syncthreads();
    const float mean = (red[0] + red[1] + red[2] + red[3]) * (1.0f / 1024.0f);
    __syncthreads();
    const float dx = v.x - mean, dy = v.y - mean, dz = v.z - mean, dw = v.w - mean;
    float q = (dx * dx + dy * dy) + (dz * dz + dw * dw);
    for (int o = 32; o > 0; o >>= 1) q += __shfl_xor(q, o);
    if ((tid & 63) == 0) red[tid >> 6] = q;
    __syncthreads();
    const float var = (red[0] + red[1] + red[2] + red[3]) * (1.0f / 1024.0f);
    const float rstd = rsqrtf(var + 1e-5f);
    const float4 gg = *(const float4*)(g + tid * 4), bb = *(const float4*)(b + tid * 4);
    float4 o; o.x = dx * rstd * gg.x + bb.x; o.y = dy * rstd * gg.y + bb.y; o.z = dz * rstd * gg.z + bb.z; o.w = dw * rstd * gg.w + bb.w;
    *(float4*)(out + (size_t)row * ld_out + tid * 4) = o;
}

__global__ void __launch_bounds__(256) spatial_gate(const float* __restrict__ z, const float* __restrict__ ws, const float* __restrict__ bs, float* __restrict__ gated) {
    const size_t idx = (size_t)blockIdx.x * 256 + threadIdx.x;
    const int t = (int)(idx >> 10), ch = (int)(idx & 1023), g = ch >> 7, tt = t & 127, t0 = t - tt;
    const float* w = ws + ((size_t)g * 128 + tt) * 128;
    float acc = 0.f;
    for (int s = 0; s <= tt; ++s) acc = fmaf(w[s], z[(size_t)(t0 + s) * 2048 + 1024 + ch], acc);
    acc += bs[g * 128 + tt];
    gated[idx] = z[(size_t)t * 2048 + ch] * acc;
}

__global__ void __launch_bounds__(256) kbar_kernel(const float* __restrict__ qkv, float* __restrict__ kbar) {
    const int idx = blockIdx.x * 256 + threadIdx.x;
    const int d = idx & 63, n = (idx >> 6) & 15, h = (idx >> 10) & 15, b = idx >> 14;
    float s = 0.f;
    for (int p = 0; p < 256; ++p) s += qkv[(size_t)(b * NS + n * 256 + p) * 3072 + 1024 + h * 64 + d];
    kbar[idx] = s * (1.0f / 256.0f);
}

__global__ void __launch_bounds__(64) moba_naive(const float* __restrict__ qkv, const float* __restrict__ kbar, const float* __restrict__ rel_bias, float* __restrict__ o_out) {
    const int idx = blockIdx.x * 64 + threadIdx.x;
    const int t = idx & 4095, h = (idx >> 12) & 15, b = idx >> 16;
    const int cur = t >> 8;
    float q[64];
    const float* qp = qkv + (size_t)(b * NS + t) * 3072 + h * 64;
#pragma unroll
    for (int d = 0; d < 64; ++d) q[d] = qp[d] * 0.125f;
    int sel[3] = {-1, -1, -1}; float sv[3] = {-INFINITY, -INFINITY, -INFINITY};
    for (int n = 0; n < cur; ++n) {
        const float* kb = kbar + ((size_t)(b * 16 + h) * 16 + n) * 64;
        float gsum = 0.f;
#pragma unroll
        for (int d = 0; d < 64; ++d) gsum = fmaf(q[d], kb[d], gsum);
        if (gsum > sv[0]) { sv[2] = sv[1]; sel[2] = sel[1]; sv[1] = sv[0]; sel[1] = sel[0]; sv[0] = gsum; sel[0] = n; }
        else if (gsum > sv[1]) { sv[2] = sv[1]; sel[2] = sel[1]; sv[1] = gsum; sel[1] = n; }
        else if (gsum > sv[2]) { sv[2] = gsum; sel[2] = n; }
    }
    float m = -INFINITY, l = 0.f; float o[64];
#pragma unroll
    for (int d = 0; d < 64; ++d) o[d] = 0.f;
#pragma unroll
    for (int j = 0; j < 4; ++j) {
        const int blk = (j < 3) ? sel[j < 3 ? j : 0] : cur;
        if (blk < 0) continue;
        const int kend = (j < 3) ? 256 : (t - cur * 256 + 1);
        for (int kk = 0; kk < kend; ++kk) {
            const int kp = blk * 256 + kk;
            const float* kr = qkv + (size_t)(b * NS + kp) * 3072 + 1024 + h * 64;
            const float* vr = kr + 1024;
            float s = 0.f;
#pragma unroll
            for (int d = 0; d < 64; ++d) s = fmaf(q[d], kr[d], s);
            int dist = t - kp; if (dist > 128) dist = 128;
            s += rel_bias[c_bucket[dist] * 16 + h];
            if (s > m) { const float f = __expf(m - s); l *= f;
#pragma unroll
                for (int d = 0; d < 64; ++d) o[d] *= f;
                m = s; }
            const float p = __expf(s - m); l += p;
#pragma unroll
            for (int d = 0; d < 64; ++d) o[d] = fmaf(p, vr[d], o[d]);
        }
    }
    const float il = 1.0f / l;
    float* op = o_out + (size_t)(b * NS + t) * 1024 + h * 64;
#pragma unroll
    for (int d = 0; d < 64; ++d) op[d] = o[d] * il;
}

__global__ void __launch_bounds__(256) conv_gate(const float* __restrict__ hbuf, const float* __restrict__ cw, const float* __restrict__ cb, float* __restrict__ gated) {
    const size_t idx = (size_t)blockIdx.x * 256 + threadIdx.x;
    const int t = (int)(idx / NF), f = (int)(idx % NF);
    float hc[2];
#pragma unroll
    for (int half = 0; half < 2; ++half) {
        const int c = half * NF + f;
        float a = cb[c] + cw[2 * NF2 + c] * hbuf[(size_t)t * NF2 + c];
        if (t >= 1) a += cw[1 * NF2 + c] * hbuf[(size_t)(t - 1) * NF2 + c];
        if (t >= 2) a += cw[0 * NF2 + c] * hbuf[(size_t)(t - 2) * NF2 + c];
        hc[half] = a;
    }
    gated[idx] = gelu_tanh(hc[0]) * hc[1];
}

struct In { const float *x, *ln_mix_g, *ln_mix_b, *ln_ffn_g, *ln_ffn_b, *a_w_in, *a_ln_g, *a_ln_b, *a_w_s, *a_b_s, *a_w_out, *b_w_qkv, *b_w_o, *rel_bias, *f_w_up, *f_conv_w, *f_conv_b, *f_w_down; };

static void forward(const In& I, float* X, float* ws, hipStream_t st, int n_layers = 4) {
    float* R0 = ws; float* R1 = ws + (size_t)48 * 1024 * 1024; float* R2 = ws + (size_t)64 * 1024 * 1024; float* KB = ws + (size_t)80 * 1024 * 1024;
    hipMemcpyAsync(X, I.x, (size_t)NM * ND * 4, hipMemcpyDeviceToDevice, st);
    for (int i = 0; i < n_layers; ++i) {
        const int j = i / 2;
        if ((i & 1) == 0) {
            gemm_f32<1><<<dim3(2048 / 128, NM / 128), 256, 0, st>>>(X, ND, I.a_w_in + (size_t)j * ND * 2048, 2048, R0, 2048, ND);
            ln_rows<<<NM, 256, 0, st>>>(R0 + 1024, 2048, nullptr, 0, 1.0f, I.a_ln_g + j * 1024, I.a_ln_b + j * 1024, R0 + 1024, 2048);
            spatial_gate<<<NM * 1024 / 256, 256, 0, st>>>(R0, I.a_w_s + (size_t)j * 8 * 128 * 128, I.a_b_s + j * 8 * 128, R1);
            gemm_f32<0><<<dim3(1024 / 128, NM / 128), 256, 0, st>>>(R1, 1024, I.a_w_out + (size_t)j * 1024 * 1024, 1024, R2, 1024, 1024);
        } else {
            gemm_f32<0><<<dim3(3072 / 128, NM / 128), 256, 0, st>>>(X, ND, I.b_w_qkv + (size_t)j * ND * 3072, 3072, R0, 3072, ND);
            kbar_kernel<<<65536 / 256, 256, 0, st>>>(R0, KB);
            moba_naive<<<NB * NH * NS / 64, 64, 0, st>>>(R0, KB, I.rel_bias, R1);
            gemm_f32<0><<<dim3(1024 / 128, NM / 128), 256, 0, st>>>(R1, 1024, I.b_w_o + (size_t)j * 1024 * 1024, 1024, R2, 1024, 1024);
        }
        ln_rows<<<NM, 256, 0, st>>>(X, ND, R2, 1024, ALPHA, I.ln_mix_g + i * 1024, I.ln_mix_b + i * 1024, X, ND);
        for (int b = 0; b < NB; ++b) {
            gemm_f32<0><<<dim3(NF2 / 128, NS / 128), 256, 0, st>>>(X + (size_t)b * NS * ND, ND, I.f_w_up + (size_t)i * ND * NF2, NF2, R0, NF2, ND);
            conv_gate<<<NS * NF / 256, 256, 0, st>>>(R0, I.f_conv_w + (size_t)i * 3 * NF2, I.f_conv_b + (size_t)i * NF2, R1);
            gemm_f32<0><<<dim3(1024 / 128, NS / 128), 256, 0, st>>>(R1, NF, I.f_w_down + (size_t)i * NF * 1024, 1024, R2 + (size_t)b * NS * ND, 1024, NF);
        }
        ln_rows<<<NM, 256, 0, st>>>(X, ND, R2, 1024, ALPHA, I.ln_ffn_g + i * 1024, I.ln_ffn_b + i * 1024, X, ND);
    }
}
}
extern "C" void kernel_launch(void* const* d_in, const int* in_sizes, int n_in, void* d_out, int out_size, void* d_ws, size_t ws_size, hipStream_t stream) {
    nv::In I;
    const float** p = (const float**)&I;
    for (int i = 0; i < 18; ++i) p[i] = (const float*)d_in[i];
    nv::forward(I, (float*)d_out, (float*)d_ws, stream);
}
```
